# Optimizing an MI355X kernel written in HIP

```python
import math
import jax, jax.numpy as jnp
from jax import lax
import numpy as np

D_MODEL = 1024
BATCH = 8
SEQ = 2048
DEPTH = 2

GRID_W = 64
CTX_LEN = 256

ATTN_HEADS = 4
ATTN_DIM = 64
ATTN_VDIM = 2 * ATTN_DIM
Q_W = ATTN_HEADS * 2 * ATTN_DIM
K_W = ATTN_HEADS * 2 * ATTN_DIM
V_W = ATTN_HEADS * ATTN_VDIM
CONV_WIDTH = D_MODEL - V_W
CONV_K = 3
IN_EVEN = Q_W + K_W + V_W + 3 * CONV_WIDTH
Q_BLOCK = 128
ROPE_BASE = 10000.0

SGU_WIDTH = D_MODEL
SGU_GROUPS = 4
CHUNK = 128

D_FF = 2816
N_EXPERTS = 8
TOP_K = 2
D_FF_EXPERT = 3584

N_EVEN = (DEPTH + 1) // 2
N_ODD = DEPTH // 2
EPS = 1e-6

kernel_name = "hybrid_diffattn_shortconv_gmlp_moe_dit"


def rmsnorm(x, g):
    xf = x.astype(jnp.float32)
    y = xf * lax.rsqrt(jnp.mean(xf * xf, axis=-1, keepdims=True) + EPS)
    return (y * g.astype(jnp.float32)).astype(x.dtype)


def layernorm(x, g, b):
    xf = x.astype(jnp.float32)
    mu = jnp.mean(xf, axis=-1, keepdims=True)
    var = jnp.mean(jnp.square(xf - mu), axis=-1, keepdims=True)
    y = (xf - mu) * lax.rsqrt(var + EPS)
    return (y * g.astype(jnp.float32) + b.astype(jnp.float32)).astype(x.dtype)


def modulate(x, g, shift, scale):
    return rmsnorm(x, g) * (1 + scale) + shift


def ada_chunks(cond, w, b):
    m = jax.nn.silu(cond) @ w + b
    return jnp.split(m, 6, axis=-1)


def axial_rope_tables(rows, dim):
    row = jnp.repeat(jnp.arange(rows), GRID_W).astype(jnp.float32)
    col = jnp.tile(jnp.arange(GRID_W), rows).astype(jnp.float32)
    quarter = dim // 4
    inv = ROPE_BASE ** (-jnp.arange(quarter, dtype=jnp.float32) / quarter)
    ar = row[:, None] * inv
    ac = col[:, None] * inv
    ang = jnp.concatenate([ar, ar, ac, ac], axis=-1)
    return jnp.cos(ang), jnp.sin(ang)


def apply_rope(t, cos, sin):
    cos = cos[:, None, None, :].astype(t.dtype)
    sin = sin[:, None, None, :].astype(t.dtype)
    t1, t2, t3, t4 = jnp.split(t, 4, axis=-1)
    rot = jnp.concatenate([-t2, t1, -t4, t3], axis=-1)
    return t * cos + rot * sin


def diff_attention(q, k, v, lam):
    B, S, H, _, d = q.shape
    nb = S // Q_BLOCK
    qb = q.reshape(B, nb, Q_BLOCK, H, 2, d).swapaxes(0, 1)
    scale = d ** -0.5

    def block(qi):
        s = jnp.einsum('bqhcd,bkhcd->bhcqk', qi, k).astype(jnp.float32) * scale
        p = jax.nn.softmax(s, axis=-1)
        w = (p[:, :, 0] - lam * p[:, :, 1]).astype(v.dtype)
        return jnp.einsum('bhqk,bkhe->bqhe', w, v)

    out = lax.map(block, qb)
    return out.swapaxes(0, 1).reshape(B, S, H, v.shape[-1])


def short_conv(x, w):
    C = x.shape[-1]
    pad = CONV_K // 2
    return lax.conv_general_dilated(
        x, w[:, None, :].astype(x.dtype), window_strides=(1,), padding=((pad, pad),),
        dimension_numbers=('NWC', 'WIO', 'NWC'), feature_group_count=C)


def even_mixer(h, hc, w_in, q_g, k_g, lq1, lk1, lq2, lk2, subln_g, conv_w, w_out,
               cos, sin, lambda_init):
    B, S, _ = h.shape
    L = hc.shape[1]
    proj = h @ w_in
    o1 = Q_W
    o2 = o1 + K_W
    o3 = o2 + V_W
    o4 = o3 + CONV_WIDTH
    o5 = o4 + CONV_WIDTH
    q, k, v, gate_b, gate_c, u = jnp.split(proj, [o1, o2, o3, o4, o5], axis=-1)
    q = apply_rope(rmsnorm(q.reshape(B, S, ATTN_HEADS, 2, ATTN_DIM), q_g), cos, sin)
    k = apply_rope(rmsnorm(k.reshape(B, S, ATTN_HEADS, 2, ATTN_DIM), k_g), cos, sin)
    v = v.reshape(B, S, ATTN_HEADS, ATTN_VDIM)
    kc, vc = jnp.split(hc @ w_in[:, o1:o3], [K_W], axis=-1)
    kc = rmsnorm(kc.reshape(B, L, ATTN_HEADS, 2, ATTN_DIM), k_g)
    vc = vc.reshape(B, L, ATTN_HEADS, ATTN_VDIM)
    k_all = jnp.concatenate([kc, k], axis=1)
    v_all = jnp.concatenate([vc, v], axis=1)
    lam = (jnp.exp(jnp.sum(lq1.astype(jnp.float32) * lk1.astype(jnp.float32)))
           - jnp.exp(jnp.sum(lq2.astype(jnp.float32) * lk2.astype(jnp.float32)))
           + lambda_init)
    attn = diff_attention(q, k_all, v_all, lam)
    attn = rmsnorm(attn, subln_g) * (1.0 - lambda_init)
    y_conv = gate_b * short_conv(gate_c * u, conv_w)
    y = jnp.concatenate([attn.reshape(B, S, V_W), y_conv], axis=-1)
    return y @ w_out


def sgu_mixer(h, w_in, ln_g, ln_b, w_s, b_s, w_out):
    B, S, _ = h.shape
    z = jax.nn.gelu(h @ w_in)
    u, v = jnp.split(z, 2, axis=-1)
    v = layernorm(v, ln_g, ln_b)
    n = S // CHUNK
    vg = v.reshape(B, n, CHUNK, SGU_GROUPS, SGU_WIDTH // SGU_GROUPS)
    s = jnp.einsum('gpq,bnqgc->bnpgc', w_s, vg) + b_s.T[:, :, None]
    return (u * s.reshape(B, S, SGU_WIDTH)) @ w_out


def swiglu(h, wg, wu, wd):
    return (jax.nn.silu(h @ wg) * (h @ wu)) @ wd


def moe_swiglu(h, router_w, wg, wu, wd):
    logits = (h @ router_w).astype(jnp.float32)
    top_v, top_i = lax.top_k(logits, TOP_K)
    gates = jax.nn.softmax(top_v, axis=-1)
    dense_gate = jnp.sum(jax.nn.one_hot(top_i, N_EXPERTS, dtype=jnp.float32)
                         * gates[..., None], axis=-2).astype(h.dtype)
    out = jnp.zeros_like(h)
    for e in range(N_EXPERTS):
        out = out + dense_gate[..., e:e + 1] * swiglu(h, wg[e], wu[e], wd[e])
    return out


def setup_inputs(seed: int = 0) -> dict:
    key = jax.random.key(seed)
    ks = iter(jax.random.split(key, 40))
    D = D_MODEL

    def nrm(shape, scale):
        return jax.random.normal(next(ks), shape, jnp.float32) * scale

    def gain(shape):
        return 1.0 + 0.01 * jax.random.normal(next(ks), shape, jnp.float32)

    return {
        "x": nrm((BATCH, SEQ, D), 1.0),
        "c": nrm((BATCH, D), 1.0),
        "ctx": nrm((BATCH, CTX_LEN, D), 1.0),
        "c_ctx": nrm((D,), 1.0),
        "ada_w": nrm((DEPTH, D, 6 * D), D ** -0.5),
        "ada_b": nrm((DEPTH, 6 * D), 0.01),
        "norm_mix_g": gain((DEPTH, D)),
        "norm_ffn_g": gain((DEPTH, D)),
        "w_in_even": nrm((N_EVEN, D, IN_EVEN), D ** -0.5),
        "q_norm_g": gain((N_EVEN, ATTN_DIM)),
        "k_norm_g": gain((N_EVEN, ATTN_DIM)),
        "lam_q1": nrm((N_EVEN, ATTN_DIM), 0.1),
        "lam_k1": nrm((N_EVEN, ATTN_DIM), 0.1),
        "lam_q2": nrm((N_EVEN, ATTN_DIM), 0.1),
        "lam_k2": nrm((N_EVEN, ATTN_DIM), 0.1),
        "subln_g": gain((N_EVEN, ATTN_VDIM)),
        "conv_w": nrm((N_EVEN, CONV_K, CONV_WIDTH), CONV_K ** -0.5),
        "w_out_even": nrm((N_EVEN, V_W + CONV_WIDTH, D), (V_W + CONV_WIDTH) ** -0.5),
        "ffn_w_gate": nrm((N_EVEN, D, D_FF), D ** -0.5),
        "ffn_w_up": nrm((N_EVEN, D, D_FF), D ** -0.5),
        "ffn_w_down": nrm((N_EVEN, D_FF, D), D_FF ** -0.5),
        "sgu_w_in": nrm((N_ODD, D, 2 * SGU_WIDTH), D ** -0.5),
        "sgu_ln_g": gain((N_ODD, SGU_WIDTH)),
        "sgu_ln_b": nrm((N_ODD, SGU_WIDTH), 0.01),
        "sgu_w_s": nrm((N_ODD, SGU_GROUPS, CHUNK, CHUNK), CHUNK ** -0.5),
        "sgu_b_s": nrm((N_ODD, SGU_GROUPS, CHUNK), 0.01),
        "sgu_w_out": nrm((N_ODD, SGU_WIDTH, D), SGU_WIDTH ** -0.5),
        "router_w": nrm((N_ODD, D, N_EXPERTS), D ** -0.5),
        "moe_w_gate": nrm((N_ODD, N_EXPERTS, D, D_FF_EXPERT), D ** -0.5),
        "moe_w_up": nrm((N_ODD, N_EXPERTS, D, D_FF_EXPERT), D ** -0.5),
        "moe_w_down": nrm((N_ODD, N_EXPERTS, D_FF_EXPERT, D), D_FF_EXPERT ** -0.5),
    }


def reference(x, c, ctx, c_ctx, ada_w, ada_b, norm_mix_g, norm_ffn_g,
              w_in_even, q_norm_g, k_norm_g, lam_q1, lam_k1, lam_q2, lam_k2, subln_g,
              conv_w, w_out_even, ffn_w_gate, ffn_w_up, ffn_w_down,
              sgu_w_in, sgu_ln_g, sgu_ln_b, sgu_w_s, sgu_b_s, sgu_w_out,
              router_w, moe_w_gate, moe_w_up, moe_w_down):
    rows = x.shape[1] // GRID_W
    cos, sin = axial_rope_tables(rows, ATTN_DIM)
    h = x
    for i in range(DEPTH):
        sm, cm, gm, sf, cf, gf = [t[:, None, :] for t in ada_chunks(c, ada_w[i], ada_b[i])]
        hm = modulate(h, norm_mix_g[i], sm, cm)
        j = i // 2
        if i % 2 == 0:
            c_sm, c_cm, _, _, _, _ = ada_chunks(c_ctx, ada_w[i], ada_b[i])
            hc = modulate(ctx, norm_mix_g[i], c_sm, c_cm)
            lambda_init = 0.8 - 0.6 * math.exp(-0.3 * i)
            h = h + gm * even_mixer(hm, hc, w_in_even[j], q_norm_g[j], k_norm_g[j],
                                    lam_q1[j], lam_k1[j], lam_q2[j], lam_k2[j], subln_g[j],
                                    conv_w[j], w_out_even[j], cos, sin, lambda_init)
            hf = modulate(h, norm_ffn_g[i], sf, cf)
            h = h + gf * swiglu(hf, ffn_w_gate[j], ffn_w_up[j], ffn_w_down[j])
        else:
            h = h + gm * sgu_mixer(hm, sgu_w_in[j], sgu_ln_g[j], sgu_ln_b[j],
                                   sgu_w_s[j], sgu_b_s[j], sgu_w_out[j])
            hf = modulate(h, norm_ffn_g[i], sf, cf)
            h = h + gf * moe_swiglu(hf, router_w[j], moe_w_gate[j], moe_w_up[j], moe_w_down[j])
    return h
```

```cpp
#include <hip/hip_runtime.h>
#include <cstdio>
#include <cstdint>

#ifndef MK_PER_PHASE
#define MK_PER_PHASE 1
#endif

#define LAS __attribute__((address_space(3)))
#define GAS __attribute__((address_space(1)))
typedef unsigned short bf16_t;
typedef short bf16x8 __attribute__((ext_vector_type(8)));
typedef short s16x4 __attribute__((ext_vector_type(4)));
typedef float f32x4 __attribute__((ext_vector_type(4)));
typedef float f32x2 __attribute__((ext_vector_type(2)));
typedef float f32x16 __attribute__((ext_vector_type(16)));
typedef unsigned u32x4 __attribute__((ext_vector_type(4)));
typedef unsigned u32x2 __attribute__((ext_vector_type(2)));
typedef __bf16 bf16x2_t __attribute__((ext_vector_type(2)));

constexpr int DM = 1024, NB = 8, SEQ = 2048, MTOK = NB * SEQ, CTXL = 256, MCTX = NB * CTXL, LK = CTXL + SEQ;
constexpr int NIN = 3072, DFF = 2816, NEXP = 8, DFE = 3584;
constexpr int NPH = 17;
constexpr float EPSN = 1e-6f;
constexpr float LOG2E = 1.4426950408889634f;
constexpr float C2Q = 0.125f * LOG2E;
constexpr int MOE_CAP = MTOK;
constexpr int MOE_ROWS = 2 * MTOK + NEXP * 256;

constexpr size_t MiB = 1u << 20;
constexpr size_t WS_CTL = 0, CTL_ZERO_BYTES = 1 * MiB;
constexpr size_t WS_MOD = 1 * MiB;
constexpr size_t WS_ROPEC = WS_MOD + 458752, WS_ROPES = WS_ROPEC + 4096, WS_SCAL = WS_ROPES + 4096;
constexpr size_t WS_LIST = 2 * MiB;
constexpr size_t WS_TINFO = WS_LIST + 524288;
constexpr size_t WS_TGATE = WS_TINFO + 262144;
constexpr size_t WS_XN = 3 * MiB;
constexpr size_t WS_MGU = 35 * MiB;
constexpr size_t WS_MD = 147 * MiB;
constexpr size_t WS_WOUT = 203 * MiB, WS_WIN = 205 * MiB, WS_WGU = 211 * MiB, WS_WD = 222 * MiB, WS_WSI = 228 * MiB, WS_WSO = 232 * MiB, WS_WS = 234 * MiB;
constexpr size_t WS_HC = 235 * MiB;
constexpr size_t WS_Q = 239 * MiB, WS_K = 255 * MiB, WS_V = 273 * MiB, WS_GB = 291 * MiB, WS_CU = 307 * MiB, WS_Y = 323 * MiB;
constexpr size_t WS_G = 239 * MiB;
constexpr size_t WS_U = 239 * MiB, WS_VV = 271 * MiB, WS_T = 303 * MiB;
constexpr size_t WS_GE = 203 * MiB;
constexpr size_t WS_PO = 3 * MiB;
constexpr size_t WS_END = 441 * MiB;
constexpr int CW_TMO = 0, CW_BAR = 4096, CW_CNT = 16384;

constexpr int RING_BYTES = 131072;
constexpr int LDSCTL_OFF = RING_BYTES, MISC_OFF = LDSCTL_OFF + 320;
constexpr int LDS_BYTES = 147456;

__device__ __forceinline__ unsigned cvtpk(float lo, float hi) { f32x2 v = {lo, hi}; bf16x2_t b = __builtin_convertvector(v, bf16x2_t); return __builtin_bit_cast(unsigned, b); }
__device__ __forceinline__ float bf2f(unsigned short h) { return __builtin_bit_cast(float, (unsigned)h << 16); }
__device__ __forceinline__ float bflo(unsigned w) { return __builtin_bit_cast(float, w << 16); }
__device__ __forceinline__ float bfhi(unsigned w) { return __builtin_bit_cast(float, w & 0xffff0000u); }
__device__ __forceinline__ float wave_sum(float v) {
#pragma unroll
    for (int o = 1; o < 64; o <<= 1) v += __shfl_xor(v, o);
    return v;
}
__device__ __forceinline__ float fast_exp2(float x) { return __builtin_amdgcn_exp2f(x); }
__device__ __forceinline__ float fast_rcp(float x) { return __builtin_amdgcn_rcpf(x); }
__device__ __forceinline__ float silu_f(float x) { return x * fast_rcp(1.0f + fast_exp2(-x * LOG2E)); }
__device__ __forceinline__ float gelu_tanh_f(float x) {
    const float y = 0.7978845608028654f * (x + 0.044715f * x * x * x);
    return x * fast_rcp(1.0f + fast_exp2(-2.0f * LOG2E * y));
}
__device__ __forceinline__ int crow(int r, int hi) { return (r & 3) + 8 * (r >> 2) + 4 * hi; }

namespace pg8 {
constexpr int BM = 256, BK = 64, HALF = 128, HTB = HALF * BK * 2, STAGE_BYTES = 8 * HTB, NXCD = 8, WGM = 8;
__host__ __device__ __forceinline__ int lds_byte(int r, int c) { const int st = (r >> 4) * 2 + (c >> 5), rr = r & 15, cc = c & 31, ob = rr * 64 + cc * 2; return st * 1024 + (ob ^ (((ob >> 9) & 1) << 5)); }
__host__ __device__ __forceinline__ void stage_rc(int b, int& R, int& C) { const int st = b / 1024, sb = b % 1024, swz = sb ^ (((sb >> 9) & 1) << 5); R = (st >> 1) * 16 + swz / 64; C = (st & 1) * 32 + (swz % 64) / 2; }
__host__ __device__ __forceinline__ int perm32(int rho) { const int n = rho >> 4, i = rho & 15; return 8 * (i >> 2) + 4 * n + (i & 3); }

struct Unit { int pm, pn, pe, gofs, gvalid; };
struct Gemm { const bf16_t* A; const bf16_t* Bt; int M, N, K; size_t bstride; const int* glist; };

struct StaticOrder {
    int nM, nN, nwg, G, c;
    __device__ void init(int M, int N, int G_, int c_) { nM = M / BM; nN = N / BM; nwg = nM * nN; G = G_; c = c_; }
    __device__ bool next(int i, Unit& u) const {
        const long L = (long)i * G + c; if (L >= nwg) return false;
        int wgid = (int)L; { const int q = nwg / NXCD, r = nwg % NXCD, xcd = wgid % NXCD, off = wgid / NXCD; wgid = (xcd < r ? xcd * (q + 1) : r * (q + 1) + (xcd - r) * q) + off; }
        const int nig = WGM * nN, gid = wgid / nig, fm = gid * WGM, gsz = (nM - fm) < WGM ? (nM - fm) : WGM;
        u.pm = fm + ((wgid % nig) % gsz); u.pn = (wgid % nig) / gsz; u.pe = 0; u.gofs = 0; u.gvalid = 256; return true;
    }
};
struct MoeOrder {
    int te[8], tb[8], cnt[8]; int nN, G, v;
    __device__ void init(const unsigned* counts, int nN_, int G_, int v_) {
        int b = 0;
#pragma unroll
        for (int e = 0; e < 8; ++e) { int c = (int)counts[64 * e]; c = c < 0 ? 0 : (c > MOE_CAP ? MOE_CAP : c); cnt[e] = c; te[e] = (c + 255) >> 8; tb[e] = b; b += te[e]; }
        nN = nN_; G = G_; v = v_;
    }
    __device__ bool next(int i, Unit& u) const {
        int l = i * G + v; int e = 0; bool found = false;
#pragma unroll
        for (int k = 0; k < 8; ++k) { if (!found) { const int n = te[k] * nN; if (l < n) { e = k; found = true; } else l -= n; } }
        if (!found) return false;
        int tE = 1, tB = 0, cN = 0;
#pragma unroll
        for (int k = 0; k < 8; ++k) if (k == e) { tE = te[k]; tB = tb[k]; cN = cnt[k]; }
        const int pml = l % tE; u.pn = l / tE; u.pm = tB + pml; u.pe = e; u.gofs = e * MOE_CAP + pml * 256; u.gvalid = cN - pml * 256; return true;
    }
};

template <class Epi, class Sched, bool ALIGN_EPI, bool GATHER>
__device__ __forceinline__ void gemm_phase(LAS unsigned char* lds, const Gemm g, const Sched& S, const Epi& E) {
    const int tid = threadIdx.x, wid = __builtin_amdgcn_readfirstlane(tid >> 6), lane = tid & 63, wr = wid >> 2, wc = wid & 3, fr = lane & 15, fq = lane >> 4;
    const int K = g.K, nt = K / BK;
    unsigned voffA[2], voffB[2]; int rowA[2];
#pragma unroll
    for (int i = 0; i < 2; ++i) { int R, C; stage_rc(tid * 16 + i * 8192, R, C); rowA[i] = R; voffA[i] = GATHER ? (unsigned)(C * 2) : (unsigned)(R * K + C) * 2u; voffB[i] = (unsigned)(R * K + C) * 2u; }
    const size_t kstep = (size_t)(BK * 2);
    const size_t hstep = (size_t)HALF * K * 2;
    const size_t tstep = 2 * hstep;
    const unsigned ldsw = (unsigned)wid * 1024u;
    const int aoff = lds_byte(wr * 64 + fr, fq * 8), boff = lds_byte(wc * 32 + fr, fq * 8);
#define PG8_SA(b, h) (((b) * 2 + (h)) * HTB)
#define PG8_SB(b, h) ((4 + (b) * 2 + (h)) * HTB)
#define PG8_STAGE(bufoff, gbase, voff) do { _Pragma("unroll") for (int _i = 0; _i < 2; ++_i) \
        __builtin_amdgcn_global_load_lds((const unsigned*)((const char*)(gbase) + (voff)[_i]), (LAS unsigned*)(lds + (bufoff) + ldsw + _i * 8192), 16, 0, 0); } while (0)
#define PG8_LDA(dst, b, h) do { _Pragma("unroll") for (int m = 0; m < 4; ++m) _Pragma("unroll") for (int k = 0; k < 2; ++k) dst[m][k] = *(const LAS bf16x8*)(lds + PG8_SA(b, h) + aoff + m * 2048 + k * 1024); } while (0)
#define PG8_LDB(dst, b, h) do { _Pragma("unroll") for (int n = 0; n < 2; ++n) _Pragma("unroll") for (int k = 0; k < 2; ++k) dst[n][k] = *(const LAS bf16x8*)(lds + PG8_SB(b, h) + boff + n * 2048 + k * 1024); } while (0)
#define PG8_MMA(ai, bj, At, Bt) do { __builtin_amdgcn_s_setprio(1); _Pragma("unroll") for (int m = 0; m < 4; ++m) _Pragma("unroll") for (int n = 0; n < 2; ++n) _Pragma("unroll") for (int k = 0; k < 2; ++k) \
        acc[ai][bj][m][n] = __builtin_amdgcn_mfma_f32_16x16x32_bf16(Bt[n][k], At[m][k], acc[ai][bj][m][n], 0, 0, 0); __builtin_amdgcn_s_setprio(0); } while (0)
#define PG8_WAIT_V(n) asm volatile("s_waitcnt vmcnt(" #n ")" ::: "memory")
#define PG8_WAIT_L(n) asm volatile("s_waitcnt lgkmcnt(" #n ")" ::: "memory")
#define PG8_BAR __builtin_amdgcn_s_barrier()
#define PG8_SCHED __builtin_amdgcn_sched_barrier(0)
    Unit cur, nxt; int ui = 0;
    if (!S.next(0, cur)) return;
    f32x4 acc[2][2][4][2];
#pragma unroll
    for (int a = 0; a < 2; ++a)
#pragma unroll
        for (int b = 0; b < 2; ++b)
#pragma unroll
            for (int m = 0; m < 4; ++m)
#pragma unroll
                for (int n = 0; n < 2; ++n) acc[a][b][m][n] = (f32x4){0.f, 0.f, 0.f, 0.f};
    bf16x8 At[4][2], B0[2][2], B1[2][2];
    const char* cA0; const char* cA1; unsigned cv0[2], cv1[2];
    const char* nA0; const char* nA1; unsigned nv0[2], nv1[2];
#define PG8_SETA(u, A0, A1, v0, v1) do { if constexpr (GATHER) { A0 = (const char*)g.A; A1 = (const char*)g.A; \
            _Pragma("unroll") for (int _i = 0; _i < 2; ++_i) { const int r0 = rowA[_i], r1 = rowA[_i] + HALF; \
                const int t0 = r0 < (u).gvalid ? g.glist[(u).gofs + r0] : 0, t1 = r1 < (u).gvalid ? g.glist[(u).gofs + r1] : 0; \
                v0[_i] = (unsigned)t0 * (unsigned)(K * 2) + voffA[_i]; v1[_i] = (unsigned)t1 * (unsigned)(K * 2) + voffA[_i]; } } \
        else { A0 = (const char*)g.A + (size_t)(u).pm * tstep; A1 = A0 + hstep; v0[0] = voffA[0]; v0[1] = voffA[1]; v1[0] = voffA[0]; v1[1] = voffA[1]; } } while (0)
    PG8_SETA(cur, cA0, cA1, cv0, cv1);
    const char* cB = (const char*)g.Bt + (size_t)cur.pe * g.bstride + (size_t)cur.pn * tstep;
    PG8_STAGE(PG8_SB(0, 0), cB, voffB); PG8_STAGE(PG8_SB(0, 1), cB + hstep, voffB); PG8_STAGE(PG8_SA(0, 0), cA0, cv0); PG8_STAGE(PG8_SA(0, 1), cA1, cv1);
    if (wr == 1) PG8_BAR;
    PG8_WAIT_V(2); PG8_BAR;
    PG8_STAGE(PG8_SB(1, 0), cB + kstep, voffB); PG8_STAGE(PG8_SA(1, 0), cA0 + kstep, cv0); PG8_STAGE(PG8_SB(1, 1), cB + hstep + kstep, voffB);
    PG8_WAIT_V(6); PG8_BAR;
    for (;;) {
        const bool has_next = S.next(ui + 1, nxt);
        const char* nB;
        if (has_next) { PG8_SETA(nxt, nA0, nA1, nv0, nv1); nB = (const char*)g.Bt + (size_t)nxt.pe * g.bstride + (size_t)nxt.pn * tstep; }
        else { nA0 = cA0; nA1 = cA1; nv0[0] = cv0[0]; nv0[1] = cv0[1]; nv1[0] = cv1[0]; nv1[1] = cv1[1]; nB = cB; }
        for (int t = 0; t < nt; t += 2) {
            const bool last = (t == nt - 2);
            const char* a1h1 = cA1 + (size_t)(t + 1) * kstep;
            const char* a2h0 = last ? nA0 : cA0 + (size_t)(t + 2) * kstep; const char* a2h1 = last ? nA1 : cA1 + (size_t)(t + 2) * kstep;
            const char* b2 = last ? nB : cB + (size_t)(t + 2) * kstep;
            const char* a3h0 = a2h0 + kstep; const char* a3h1 = a2h1 + kstep; const char* b3 = b2 + kstep;
            unsigned w0[2], w1[2];
            if constexpr (GATHER) { w0[0] = last ? nv0[0] : cv0[0]; w0[1] = last ? nv0[1] : cv0[1]; w1[0] = last ? nv1[0] : cv1[0]; w1[1] = last ? nv1[1] : cv1[1]; }
            else { w0[0] = voffA[0]; w0[1] = voffA[1]; w1[0] = voffA[0]; w1[1] = voffA[1]; }
            PG8_LDB(B0, 0, 0); PG8_LDB(B1, 0, 1); PG8_SCHED; PG8_LDA(At, 0, 0); PG8_STAGE(PG8_SA(1, 1), a1h1, cv1);
            PG8_WAIT_V(8); PG8_WAIT_L(0); PG8_BAR; PG8_MMA(0, 0, At, B0); PG8_MMA(0, 1, At, B1); PG8_BAR; PG8_SCHED;
            PG8_LDA(At, 0, 1); PG8_STAGE(PG8_SB(0, 0), b2, voffB); PG8_STAGE(PG8_SB(0, 1), b2 + hstep, voffB); PG8_STAGE(PG8_SA(0, 0), a2h0, w0);
            PG8_WAIT_V(8); PG8_WAIT_L(0); PG8_BAR; PG8_MMA(1, 0, At, B0); PG8_MMA(1, 1, At, B1); PG8_BAR; PG8_SCHED;
            PG8_LDB(B0, 1, 0); PG8_LDB(B1, 1, 1); PG8_SCHED; PG8_LDA(At, 1, 0); PG8_STAGE(PG8_SA(0, 1), a2h1, w1);
            PG8_WAIT_V(8); PG8_WAIT_L(0); PG8_BAR; PG8_MMA(0, 0, At, B0); PG8_MMA(0, 1, At, B1); PG8_BAR; PG8_SCHED;
            PG8_LDA(At, 1, 1); PG8_STAGE(PG8_SB(1, 0), b3, voffB); PG8_STAGE(PG8_SB(1, 1), b3 + hstep, voffB); PG8_STAGE(PG8_SA(1, 0), a3h0, w0);
            PG8_WAIT_V(8); PG8_WAIT_L(0); PG8_BAR; PG8_MMA(1, 0, At, B0); PG8_MMA(1, 1, At, B1); PG8_BAR; PG8_SCHED;
        }
        if constexpr (ALIGN_EPI) { if (wr == 0) PG8_BAR; }
        E(acc, cur, wr, wc, fr, fq);
        if (!has_next) break;
#pragma unroll
        for (int a = 0; a < 2; ++a)
#pragma unroll
            for (int b = 0; b < 2; ++b)
#pragma unroll
                for (int m = 0; m < 4; ++m)
#pragma unroll
                    for (int n = 0; n < 2; ++n) acc[a][b][m][n] = (f32x4){0.f, 0.f, 0.f, 0.f};
        cur = nxt; cA0 = nA0; cA1 = nA1; cv0[0] = nv0[0]; cv0[1] = nv0[1]; cv1[0] = nv1[0]; cv1[1] = nv1[1]; cB = nB; ++ui;
        if constexpr (ALIGN_EPI) { if (wr == 1) PG8_BAR; }
    }
    PG8_WAIT_V(0);
    if constexpr (!ALIGN_EPI) { if (wr == 0) PG8_BAR; }
    PG8_BAR;
#undef PG8_SETA
#undef PG8_SA
#undef PG8_SB
#undef PG8_STAGE
#undef PG8_LDA
#undef PG8_LDB
#undef PG8_MMA
#undef PG8_WAIT_V
#undef PG8_WAIT_L
#undef PG8_BAR
#undef PG8_SCHED
}


struct EpiInProj {
    bf16_t *Q, *Kb, *Vb, *GB, *CU; const float *qg, *kg, *ropec, *ropes; int ctx;
    __device__ __forceinline__ void operator()(const f32x4 (&acc)[2][2][4][2], const Unit& u, int wr, int wc, int fr, int fq) const {
        const int pn = ctx ? u.pn + 2 : u.pn;
        const int row0 = u.pm * BM + wr * 64 + fr;
        if (pn < 4) {
            const bool isq = pn < 2; const int hc = 4 * (pn & 1) + wc; const float* g = isq ? qg : kg;
            f32x4 gv[2][2];
#pragma unroll
            for (int bj = 0; bj < 2; ++bj)
#pragma unroll
                for (int n = 0; n < 2; ++n) gv[bj][n] = *(const f32x4*)(g + 32 * bj + 16 * n + 4 * fq);
#pragma unroll
            for (int ai = 0; ai < 2; ++ai)
#pragma unroll
                for (int m = 0; m < 4; ++m) {
                    const int row = row0 + ai * HALF + m * 16;
                    float ss = 0.f;
#pragma unroll
                    for (int bj = 0; bj < 2; ++bj)
#pragma unroll
                        for (int n = 0; n < 2; ++n) { const f32x4 x = acc[ai][bj][m][n]; ss += (x[0] * x[0] + x[1] * x[1]) + (x[2] * x[2] + x[3] * x[3]); }
                    ss += __shfl_xor(ss, 16); ss += __shfl_xor(ss, 32);
                    const float rstd = __builtin_amdgcn_rsqf(ss * (1.0f / 64.0f) + EPSN);
                    int krow, rp = 0, cp = 0;
                    if (ctx) { krow = (row >> 8) * LK + (row & 255); }
                    else { const int t = row & (SEQ - 1); krow = (row >> 11) * LK + CTXL + t; rp = t >> 6; cp = t & 63; }
                    bf16_t* dst = isq ? (Q + (size_t)row * 512 + 64 * hc) : (Kb + (size_t)krow * 512 + 64 * hc);
#pragma unroll
                    for (int bj = 0; bj < 2; ++bj) {
                        f32x4 y0 = acc[ai][bj][m][0] * rstd * gv[bj][0], y1 = acc[ai][bj][m][1] * rstd * gv[bj][1];
                        if (!ctx) {
                            const int pos = bj ? cp : rp;
                            const f32x4 c4 = *(const f32x4*)(ropec + pos * 16 + 4 * fq), s4 = *(const f32x4*)(ropes + pos * 16 + 4 * fq);
                            const f32x4 o0 = y0 * c4 - y1 * s4, o1 = y1 * c4 + y0 * s4; y0 = o0; y1 = o1;
                        }
                        if (isq) { y0 = y0 * C2Q; y1 = y1 * C2Q; }
                        u32x2 w0, w1; w0.x = cvtpk(y0[0], y0[1]); w0.y = cvtpk(y0[2], y0[3]); w1.x = cvtpk(y1[0], y1[1]); w1.y = cvtpk(y1[2], y1[3]);
                        *(u32x2*)(dst + 32 * bj + 4 * fq) = w0; *(u32x2*)(dst + 32 * bj + 16 + 4 * fq) = w1;
                    }
                }
        } else if (pn < 8) {
            const bool isv = pn < 6;
#pragma unroll
            for (int ai = 0; ai < 2; ++ai)
#pragma unroll
                for (int m = 0; m < 4; ++m) {
                    const int row = row0 + ai * HALF + m * 16;
                    int krow; if (ctx) krow = (row >> 8) * LK + (row & 255); else krow = (row >> 11) * LK + CTXL + (row & (SEQ - 1));
                    bf16_t* dst = isv ? (Vb + (size_t)krow * 512 + 256 * (pn - 4)) : (GB + (size_t)row * 512 + 256 * (pn - 6));
#pragma unroll
                    for (int bj = 0; bj < 2; ++bj) { const f32x4 v0 = acc[ai][bj][m][0], v1 = acc[ai][bj][m][1];
                        u32x4 w; w.x = cvtpk(v0[0], v0[1]); w.y = cvtpk(v0[2], v0[3]); w.z = cvtpk(v1[0], v1[1]); w.w = cvtpk(v1[2], v1[3]);
                        *(u32x4*)(dst + 128 * bj + 32 * wc + 8 * fq) = w; }
                }
        } else {
#pragma unroll
            for (int ai = 0; ai < 2; ++ai)
#pragma unroll
                for (int m = 0; m < 4; ++m) {
                    const int row = row0 + ai * HALF + m * 16;
                    const f32x4 v0 = acc[ai][0][m][0] * acc[ai][1][m][0], v1 = acc[ai][0][m][1] * acc[ai][1][m][1];
                    u32x4 w; w.x = cvtpk(v0[0], v0[1]); w.y = cvtpk(v0[2], v0[3]); w.z = cvtpk(v1[0], v1[1]); w.w = cvtpk(v1[2], v1[3]);
                    *(u32x4*)(CU + (size_t)row * 512 + 128 * (pn - 8) + 32 * wc + 8 * fq) = w;
                }
        }
    }
};
struct EpiResid {
    const float* base; float* out; const float* gate;
    __device__ __forceinline__ void operator()(const f32x4 (&acc)[2][2][4][2], const Unit& u, int wr, int wc, int fr, int fq) const {
        const int row0 = u.pm * BM + wr * 64 + fr, col0 = u.pn * BM + wc * 32 + 8 * fq;
        const float* gp = gate + (size_t)(u.pm >> 3) * 6144 + col0;
        f32x4 gv[2][2];
#pragma unroll
        for (int bj = 0; bj < 2; ++bj)
#pragma unroll
            for (int n = 0; n < 2; ++n) gv[bj][n] = *(const f32x4*)(gp + bj * HALF + 4 * n);
#pragma unroll
        for (int ai = 0; ai < 2; ++ai)
#pragma unroll
            for (int m = 0; m < 4; ++m) { const size_t off = (size_t)(row0 + ai * HALF + m * 16) * DM + col0;
#pragma unroll
                for (int bj = 0; bj < 2; ++bj)
#pragma unroll
                    for (int n = 0; n < 2; ++n) { const f32x4 b = *(const f32x4*)(base + off + bj * HALF + 4 * n); *(f32x4*)(out + off + bj * HALF + 4 * n) = b + gv[bj][n] * acc[ai][bj][m][n]; } }
    }
};
struct EpiSwiGLU {
    bf16_t* O; int ldc;
    __device__ __forceinline__ void operator()(const f32x4 (&acc)[2][2][4][2], const Unit& u, int wr, int wc, int fr, int fq) const {
        const int row0 = u.pm * BM + wr * 64 + fr, col0 = u.pn * HALF + wc * 32 + 8 * fq;
#pragma unroll
        for (int ai = 0; ai < 2; ++ai)
#pragma unroll
            for (int m = 0; m < 4; ++m) {
                f32x4 v[2];
#pragma unroll
                for (int n = 0; n < 2; ++n) { const f32x4 a = acc[ai][0][m][n], b = acc[ai][1][m][n];
                    v[n] = (f32x4){silu_f(a[0]) * b[0], silu_f(a[1]) * b[1], silu_f(a[2]) * b[2], silu_f(a[3]) * b[3]}; }
                u32x4 w; w.x = cvtpk(v[0][0], v[0][1]); w.y = cvtpk(v[0][2], v[0][3]); w.z = cvtpk(v[1][0], v[1][1]); w.w = cvtpk(v[1][2], v[1][3]);
                *(u32x4*)(O + (size_t)(row0 + ai * HALF + m * 16) * ldc + col0) = w;
            }
    }
};
struct EpiSguIn {
    bf16_t *U, *V;
    __device__ __forceinline__ void operator()(const f32x4 (&acc)[2][2][4][2], const Unit& u, int wr, int wc, int fr, int fq) const {
        const int row0 = u.pm * BM + wr * 64 + fr; bf16_t* O = u.pn < 4 ? U : V; const int col0 = (u.pn & 3) * BM + wc * 32 + 8 * fq;
#pragma unroll
        for (int ai = 0; ai < 2; ++ai)
#pragma unroll
            for (int m = 0; m < 4; ++m)
#pragma unroll
                for (int bj = 0; bj < 2; ++bj) { const f32x4 a = acc[ai][bj][m][0], b = acc[ai][bj][m][1];
                    u32x4 w; w.x = cvtpk(gelu_tanh_f(a[0]), gelu_tanh_f(a[1])); w.y = cvtpk(gelu_tanh_f(a[2]), gelu_tanh_f(a[3])); w.z = cvtpk(gelu_tanh_f(b[0]), gelu_tanh_f(b[1])); w.w = cvtpk(gelu_tanh_f(b[2]), gelu_tanh_f(b[3]));
                    *(u32x4*)(O + (size_t)(row0 + ai * HALF + m * 16) * DM + col0 + bj * HALF) = w; }
    }
};
struct EpiF32 {
    float* C;
    __device__ __forceinline__ void operator()(const f32x4 (&acc)[2][2][4][2], const Unit& u, int wr, int wc, int fr, int fq) const {
        const int row0 = u.pm * BM + wr * 64 + fr, col0 = u.pn * BM + wc * 32 + 8 * fq;
#pragma unroll
        for (int ai = 0; ai < 2; ++ai)
#pragma unroll
            for (int m = 0; m < 4; ++m) { float* rp = C + (size_t)(row0 + ai * HALF + m * 16) * DM + col0;
#pragma unroll
                for (int bj = 0; bj < 2; ++bj)
#pragma unroll
                    for (int n = 0; n < 2; ++n) *(f32x4*)(rp + bj * HALF + 4 * n) = acc[ai][bj][m][n]; }
    }
};
}

typedef GAS unsigned gu32;
#define XB_TMO      128
#define XB_XCNT(j)  (256  + 64 * (j))
#define XB_XSUB(j)  (1280 + 64 * (j))
#define XB_XGEN(j)  (2304 + 64 * (j))
#define XB_TOP      3328
#define XB_TOPGEN   3392
#define XCD_BAR_WORDS 3456
#define XB_SPIN_CAP (1u << 18)
__device__ __forceinline__ unsigned xb_ld(unsigned* p)              { return __hip_atomic_load(p, __ATOMIC_RELAXED, __HIP_MEMORY_SCOPE_AGENT); }
__device__ __forceinline__ unsigned xb_add(unsigned* p, unsigned v) { return __hip_atomic_fetch_add(p, v, __ATOMIC_RELAXED, __HIP_MEMORY_SCOPE_AGENT); }
__device__ __forceinline__ unsigned xb_xcc_id() { return (unsigned)__builtin_amdgcn_s_getreg((3 << 11) | 20) & 0xFu; }
#define XB_SPIN(cond, bar) do { unsigned _sp = 0; while (cond) { __builtin_amdgcn_s_sleep(1); \
    if ((++_sp & 255u) == 0u) { if (xb_ld(&(bar)[XB_TMO])) break; if (_sp > XB_SPIN_CAP) { atomicAdd(&(bar)[XB_TMO], 1u); break; } } } } while (0)
struct XcdBarrier { unsigned* bar; unsigned x; volatile LAS unsigned* st; };
__device__ __forceinline__ XcdBarrier xcd_barrier_post(unsigned* bar, volatile LAS unsigned* st) {
    XcdBarrier b; b.bar = bar; b.x = xb_xcc_id(); b.st = st;
    if (threadIdx.x == 0) (void)xb_add(&bar[XB_XCNT(b.x)], 1u);
    return b;
}
__device__ __forceinline__ void xcd_barrier_complete(unsigned* bar, unsigned x, unsigned& nloc, unsigned& nx) {
    const unsigned G = gridDim.x * gridDim.y * gridDim.z;
    unsigned sum, cnt, mine, sp = 0u;
    for (;;) {
        sum = 0u; cnt = 0u; mine = 0u;
#pragma unroll
        for (unsigned j = 0; j < 16; ++j) { const unsigned c = xb_ld(&bar[XB_XCNT(j)]); sum += c; cnt += (c > 0u) ? 1u : 0u; mine = (j == x) ? c : mine; }
        if (sum == G) break;
        __builtin_amdgcn_s_sleep(1);
        if ((++sp & 255u) == 0u) { if (xb_ld(&bar[XB_TMO])) break; if (sp > XB_SPIN_CAP) { atomicAdd(&bar[XB_TMO], 1u); break; } }
    }
    nloc = mine > 0u ? mine : 1u; nx = cnt > 0u ? cnt : 1u;
}
__device__ __forceinline__ void xcd_barrier(const XcdBarrier& b) {
    asm volatile("s_waitcnt vmcnt(0)" ::: "memory");
    __syncthreads();
    if (threadIdx.x == 0) {
        unsigned* bar = b.bar;
        __builtin_amdgcn_s_waitcnt(0);
        unsigned nloc = b.st[0], nx = b.st[1];
        if (nloc == 0u) { xcd_barrier_complete(bar, b.x, nloc, nx); b.st[0] = nloc; b.st[1] = nx; }
        const unsigned old = xb_add(&bar[XB_XSUB(b.x)], 1u);
        const unsigned gen = old / nloc;
        if (old + 1u == (gen + 1u) * nloc) {
            __builtin_amdgcn_fence(__ATOMIC_RELEASE, "agent");
            asm volatile("s_waitcnt vmcnt(0)" ::: "memory");
            const unsigned og = xb_add(&bar[XB_TOP], 1u);
            const unsigned tg = og / nx;
            if (og + 1u == (tg + 1u) * nx) xb_add(&bar[XB_TOPGEN], 1u);
            else XB_SPIN(xb_ld(&bar[XB_TOPGEN]) == tg, bar);
            __builtin_amdgcn_fence(__ATOMIC_ACQUIRE, "agent");
            xb_add(&bar[XB_XGEN(b.x)], 1u);
            asm volatile("s_waitcnt vmcnt(0)" ::: "memory");
        } else {
            XB_SPIN(xb_ld(&bar[XB_XGEN(b.x)]) == gen, bar);
            __builtin_amdgcn_fence(__ATOMIC_ACQUIRE, "agent");
            asm volatile("s_waitcnt vmcnt(0)" ::: "memory");
        }
    }
    __syncthreads();
}

struct Args {
    const float* in[31]; float* out; unsigned char* ws; int ph_lo, ph_hi;
};
struct Frame {
    LAS unsigned char* lds; int tid, lane, wave, vcu, G;
    unsigned char* ws;
};
enum { I_X = 0, I_C, I_CTX, I_CCTX, I_ADAW, I_ADAB, I_NMIXG, I_NFFNG, I_WIN, I_QG, I_KG, I_LQ1, I_LK1, I_LQ2, I_LK2, I_SUBG, I_CONVW, I_WOUT, I_FWG, I_FWU, I_FWD,
       I_SWIN, I_SLNG, I_SLNB, I_SWS, I_SBS, I_SWOUT, I_RW, I_MWG, I_MWU, I_MWD };

__device__ __forceinline__ void conv_item(const float* W, int Nsrc, int K, int c0, int perm, bf16_t* WT, int n0, int kb, LAS unsigned* scr, int lane) {
    const int k0 = 64 * kb;
    const float* src = W + (size_t)(k0 + 2 * (lane >> 3)) * Nsrc + c0 + 4 * (lane & 7);
#pragma unroll
    for (int i = 0; i < 4; ++i) {
        const f32x4 a = *(const f32x4*)(src + (size_t)(16 * i) * Nsrc), b = *(const f32x4*)(src + (size_t)(16 * i + 1) * Nsrc);
        const int kdw = 8 * i + (lane >> 3);
#pragma unroll
        for (int e = 0; e < 4; ++e) scr[(4 * (lane & 7) + e) * 33 + kdw] = cvtpk(a[e], b[e]);
    }
    asm volatile("s_waitcnt lgkmcnt(0)" ::: "memory");
    const int c = lane & 7;
#pragma unroll
    for (int j = 0; j < 4; ++j) {
        const int rho = (lane >> 3) + 8 * j; const int sc = perm ? pg8::perm32(rho) : rho;
        const LAS unsigned* s = scr + sc * 33 + 4 * c;
        u32x4 o; o.x = s[0]; o.y = s[1]; o.z = s[2]; o.w = s[3];
        *(u32x4*)(WT + (size_t)(n0 + rho) * K + k0 + 8 * c) = o;
    }
    asm volatile("s_waitcnt lgkmcnt(0)" ::: "memory");
}
constexpr int J_WIN = (NIN / 32) * (DM / 64);
constexpr int J_WOUT = (DM / 32) * (DM / 64);
constexpr int J_WGU = (2 * DFF / 32) * (DM / 64);
constexpr int J_WD = (DM / 32) * (DFF / 64);
constexpr int J_WSI = (2 * DM / 32) * (DM / 64);
constexpr int J_WSO = J_WOUT;
constexpr int J_MGU1 = (2 * DFE / 32) * (DM / 64);
constexpr int J_MD1 = (DM / 32) * (DFE / 64);
constexpr int JB_WIN = 0, JB_WOUT = JB_WIN + J_WIN, JB_WGU = JB_WOUT + J_WOUT, JB_WD = JB_WGU + J_WGU, JB_WSI = JB_WD + J_WD, JB_WSO = JB_WSI + J_WSI,
              JB_MGU = JB_WSO + J_WSO, JB_MD = JB_MGU + 8 * J_MGU1, JB_END = JB_MD + 8 * J_MD1;
__device__ __forceinline__ void conv_job(const Args& a, int job, LAS unsigned* scr, int lane) {
    unsigned char* ws = a.ws;
    if (job < JB_WOUT) {
        const int j = job - JB_WIN, kb = j & 15, grp = j >> 4;
        const int tile = grp >> 3, bj = (grp >> 2) & 1, wc = grp & 3;
        int c0, perm;
        if (tile < 4) { c0 = 256 * tile + 64 * wc + 32 * bj; perm = 0; }
        else if (tile < 8) { c0 = 256 * tile + 128 * bj + 32 * wc; perm = 1; }
        else { c0 = (bj ? 2560 : 2048) + 128 * (tile - 8) + 32 * wc; perm = 1; }
        conv_item(a.in[I_WIN], NIN, DM, c0, perm, (bf16_t*)(ws + WS_WIN), 32 * grp, kb, scr, lane);
    } else if (job < JB_WGU) {
        const int j = job - JB_WOUT, kb = j & 15, grp = j >> 4;
        conv_item(a.in[I_WOUT], DM, DM, 32 * grp, 1, (bf16_t*)(ws + WS_WOUT), 32 * grp, kb, scr, lane);
    } else if (job < JB_WD) {
        const int j = job - JB_WGU, kb = j & 15, grp = j >> 4, tile = grp >> 3, bj = (grp >> 2) & 1, wc = grp & 3;
        conv_item(bj ? a.in[I_FWU] : a.in[I_FWG], DFF, DM, 128 * tile + 32 * wc, 1, (bf16_t*)(ws + WS_WGU), 32 * grp, kb, scr, lane);
    } else if (job < JB_WSI) {
        const int j = job - JB_WD, kb = j % (DFF / 64), grp = j / (DFF / 64);
        conv_item(a.in[I_FWD], DM, DFF, 32 * grp, 1, (bf16_t*)(ws + WS_WD), 32 * grp, kb, scr, lane);
    } else if (job < JB_WSO) {
        const int j = job - JB_WSI, kb = j & 15, grp = j >> 4;
        conv_item(a.in[I_SWIN], 2 * DM, DM, 32 * grp, 1, (bf16_t*)(ws + WS_WSI), 32 * grp, kb, scr, lane);
    } else if (job < JB_MGU) {
        const int j = job - JB_WSO, kb = j & 15, grp = j >> 4;
        conv_item(a.in[I_SWOUT], DM, DM, 32 * grp, 1, (bf16_t*)(ws + WS_WSO), 32 * grp, kb, scr, lane);
    } else if (job < JB_MD) {
        const int jj = job - JB_MGU, e = jj / J_MGU1, j = jj % J_MGU1, kb = j & 15, grp = j >> 4, tile = grp >> 3, bj = (grp >> 2) & 1, wc = grp & 3;
        const float* W = (bj ? a.in[I_MWU] : a.in[I_MWG]) + (size_t)e * DM * DFE;
        conv_item(W, DFE, DM, 128 * tile + 32 * wc, 1, (bf16_t*)(ws + WS_MGU) + (size_t)e * (2 * DFE) * DM, 32 * grp, kb, scr, lane);
    } else {
        const int jj = job - JB_MD, e = jj / J_MD1, j = jj % J_MD1, kb = j % (DFE / 64), grp = j / (DFE / 64);
        conv_item(a.in[I_MWD] + (size_t)e * DFE * DM, DM, DFE, 32 * grp, 1, (bf16_t*)(ws + WS_MD) + (size_t)e * DM * DFE, 32 * grp, kb, scr, lane);
    }
}
__device__ __forceinline__ void conv_range(const Args& a, const Frame& F, int lo, int hi, int gw, int ngw) {
    LAS unsigned* scr = (LAS unsigned*)(F.lds + F.wave * 8192);
    for (int job = lo + gw; job < hi; job += ngw) conv_job(a, job, scr, F.lane);
}

__device__ __forceinline__ void ada_phase(const Args& a, const Frame& F) {
    LAS float* sv = (LAS float*)F.lds;
    LAS float* part = (LAS float*)(F.lds + 40960);
    const float* c = a.in[I_C]; const float* cc = a.in[I_CCTX];
    float* mod = (float*)(a.ws + WS_MOD);
    bool have = false;
    for (int it = F.vcu; it < 192; it += F.G) {
        if (!have) {
            for (int i = F.tid; i < 9 * 1024; i += 512) { const float v = i < 8192 ? c[i] : cc[i - 8192]; sv[i] = v * (1.0f / (1.0f + __expf(-v))); }
            __syncthreads(); have = true;
        }
        const int layer = it / 96, cb = it % 96, col = 64 * cb + F.lane;
        const float* W = a.in[I_ADAW] + (size_t)layer * DM * 6144 + col;
        float acc[9];
#pragma unroll
        for (int b = 0; b < 9; ++b) acc[b] = 0.f;
        const int kbeg = 128 * F.wave;
#pragma unroll 2
        for (int k = kbeg; k < kbeg + 128; k += 4) {
            const float w0 = W[(size_t)k * 6144], w1 = W[(size_t)(k + 1) * 6144], w2 = W[(size_t)(k + 2) * 6144], w3 = W[(size_t)(k + 3) * 6144];
#pragma unroll
            for (int b = 0; b < 9; ++b) { const f32x4 s = *(const LAS f32x4*)(sv + b * 1024 + k); acc[b] += s[0] * w0 + s[1] * w1 + s[2] * w2 + s[3] * w3; }
        }
#pragma unroll
        for (int b = 0; b < 9; ++b) part[(F.wave * 9 + b) * 64 + F.lane] = acc[b];
        __syncthreads();
        for (int i = F.tid; i < 9 * 64; i += 512) {
            const int b = i >> 6, x = i & 63; float s = 0.f;
#pragma unroll
            for (int w = 0; w < 8; ++w) s += part[(w * 9 + b) * 64 + x];
            mod[((size_t)layer * 9 + b) * 6144 + 64 * cb + x] = s + a.in[I_ADAB][layer * 6144 + 64 * cb + x];
        }
        __syncthreads();
    }
}
__device__ __forceinline__ void tables_phase(const Args& a, const Frame& F) {
    float* rc = (float*)(a.ws + WS_ROPEC); float* rs = (float*)(a.ws + WS_ROPES); float* sc = (float*)(a.ws + WS_SCAL);
    for (int i = F.tid; i < 1024; i += 512) {
        const int pos = i >> 4, f = i & 15;
        const float inv = powf(10000.0f, -(float)f / 16.0f);
        const float ang = (float)pos * inv;
        rc[i] = cosf(ang); rs[i] = sinf(ang);
    }
    if (F.wave == 0) {
        const int l = F.lane;
        const float d1 = wave_sum(a.in[I_LQ1][l] * a.in[I_LK1][l]), d2 = wave_sum(a.in[I_LQ2][l] * a.in[I_LK2][l]);
        float mq = fabsf(a.in[I_QG][l]), mk = fabsf(a.in[I_KG][l]);
#pragma unroll
        for (int o = 1; o < 64; o <<= 1) { mq = fmaxf(mq, __shfl_xor(mq, o)); mk = fmaxf(mk, __shfl_xor(mk, o)); }
        if (l == 0) { sc[0] = expf(d1) - expf(d2) + 0.2f;
                      sc[1] = -(64.0f * C2Q * mq * mk * 1.01f); }
    }
}
__device__ __forceinline__ void modulate_row(const float* xrow, bf16_t* orow, const float* g, const float* shift, const float* scale, int lane, f32x4 (&y)[4]) {
    const f32x4* xr = (const f32x4*)xrow + lane;
    f32x4 v[4]; float s = 0.f;
#pragma unroll
    for (int j = 0; j < 4; ++j) { v[j] = xr[64 * j]; s += (v[j][0] * v[j][0] + v[j][1] * v[j][1]) + (v[j][2] * v[j][2] + v[j][3] * v[j][3]); }
    const float rstd = 1.0f / sqrtf(wave_sum(s) * (1.0f / DM) + EPSN);
    unsigned long long* o8 = (unsigned long long*)orow + lane;
#pragma unroll
    for (int j = 0; j < 4; ++j) {
        const f32x4 gg = ((const f32x4*)g)[lane + 64 * j], sh = ((const f32x4*)shift)[lane + 64 * j], sl = ((const f32x4*)scale)[lane + 64 * j];
        y[j] = v[j] * rstd * gg * (sl + 1.0f) + sh;
        o8[64 * j] = (unsigned long long)cvtpk(y[j][0], y[j][1]) | ((unsigned long long)cvtpk(y[j][2], y[j][3]) << 32);
    }
}
__device__ __forceinline__ void modulate_phase(const Args& a, const Frame& F, const float* h, int layer, const float* g, int ch_shift, int ch_scale) {
    const float* mod = (const float*)(a.ws + WS_MOD) + (size_t)layer * 9 * 6144;
    bf16_t* XN = (bf16_t*)(a.ws + WS_XN);
    const int gw = F.vcu * 8 + F.wave, ngw = F.G * 8;
    for (int m = gw; m < MTOK; m += ngw) { const float* mb = mod + (size_t)(m >> 11) * 6144; f32x4 y[4];
        modulate_row(h + (size_t)m * DM, XN + (size_t)m * DM, g, mb + ch_shift * 1024, mb + ch_scale * 1024, F.lane, y); }
}

__device__ __forceinline__ s16x4 vtr(const LAS unsigned char* p) { typedef short v4i16_t __attribute__((ext_vector_type(4))); return __builtin_bit_cast(s16x4, __builtin_amdgcn_ds_read_tr16_b64_v4i16((LAS v4i16_t*)p)); }
#define MFMA32(a, b, c) __builtin_amdgcn_mfma_f32_32x32x16_bf16(a, b, c, 0, 0, 0)
__device__ __forceinline__ void attn_unit(const Args& a, const Frame& F, int b, int h, int qb) {
    const int lane = F.lane, r32 = lane & 31, hi = lane >> 5, wid = F.wave;
    LAS unsigned char* lds = F.lds;
    constexpr int KB0 = 0, VB0 = 16384, WSF = 49152;
    LAS float* wsf = (LAS float*)(lds + WSF) + wid * 64;
    const bf16_t* Qb = (const bf16_t*)(a.ws + WS_Q); const bf16_t* Kbuf = (const bf16_t*)(a.ws + WS_K); const bf16_t* Vbuf = (const bf16_t*)(a.ws + WS_V);
    const float* sc = (const float*)(a.ws + WS_SCAL);
    const float lam = sc[0];
    u32x4 resp[4][2];
    f32x16 o[4];
    const int NT = LK / 64;
    for (int comp = 0; comp < 2; ++comp) {
        const int hc = 2 * h + comp;
        const bf16_t* Qw = Qb + (size_t)(b * SEQ + qb * 256 + wid * 32) * 512 + 64 * hc;
        bf16x8 qr[4];
#pragma unroll
        for (int d0 = 0; d0 < 4; ++d0) qr[d0] = *(const bf16x8*)(Qw + (size_t)r32 * 512 + d0 * 16 + hi * 8);
        const bf16_t* ksrc = Kbuf + ((size_t)b * LK + lane) * 512 + 64 * hc + wid * 8;
        const bf16_t* vsrc0 = Vbuf + ((size_t)b * LK + 16 * ((2 * wid) & 3) + (lane >> 2)) * 512 + 128 * h + 32 * ((2 * wid) >> 2) + 8 * (lane & 3);
        const bf16_t* vsrc1 = Vbuf + ((size_t)b * LK + 16 * ((2 * wid + 1) & 3) + (lane >> 2)) * 512 + 128 * h + 32 * ((2 * wid + 1) >> 2) + 8 * (lane & 3);
        const int kdst = wid * 1024 + lane * 16, vdst0 = (2 * wid) * 1024 + lane * 16, vdst1 = (2 * wid + 1) * 1024 + lane * 16;
#pragma unroll
        for (int d = 0; d < 4; ++d)
#pragma unroll
            for (int r = 0; r < 16; ++r) o[d][r] = 0.f;
        float lsum = 0.f;
        u32x4 kreg = *(const u32x4*)ksrc, vreg0 = *(const u32x4*)vsrc0, vreg1 = *(const u32x4*)vsrc1;
        *(LAS u32x4*)(lds + KB0 + kdst) = kreg; *(LAS u32x4*)(lds + VB0 + vdst0) = vreg0; *(LAS u32x4*)(lds + VB0 + vdst1) = vreg1;
        __syncthreads();
        const int vaddr = ((lane >> 4) & 1) * 32 + (lane & 3) * 8 + (4 * hi + ((lane & 15) >> 2)) * 64;
        for (int t = 0; t < NT; ++t) {
            const int cur = t & 1;
            if (t + 1 < NT) { const size_t adv = (size_t)(t + 1) * 64 * 512; kreg = *(const u32x4*)(ksrc + adv); vreg0 = *(const u32x4*)(vsrc0 + adv); vreg1 = *(const u32x4*)(vsrc1 + adv); }
            const LAS unsigned char* kb = lds + KB0 + cur * 8192 + hi * 1024 + r32 * 16;
            f32x16 p0, p1;
#pragma unroll
            for (int r = 0; r < 16; ++r) { p0[r] = 0.f; p1[r] = 0.f; }
#pragma unroll
            for (int d0 = 0; d0 < 4; ++d0) {
                const bf16x8 b0 = *(const LAS bf16x8*)(kb + d0 * 2048), b1 = *(const LAS bf16x8*)(kb + d0 * 2048 + 512);
                p0 = MFMA32(b0, qr[d0], p0); p1 = MFMA32(b1, qr[d0], p1);
            }
            float sacc = 0.f;
#pragma unroll
            for (int r = 0; r < 16; ++r) { p0[r] = fast_exp2(p0[r]); p1[r] = fast_exp2(p1[r]); sacc += p0[r] + p1[r]; }
            lsum += sacc;
            u32x4 pw[4];
#pragma unroll
            for (int i = 0; i < 4; ++i) { pw[0][i] = cvtpk(p0[2 * i], p0[2 * i + 1]); pw[1][i] = cvtpk(p0[8 + 2 * i], p0[8 + 2 * i + 1]); pw[2][i] = cvtpk(p1[2 * i], p1[2 * i + 1]); pw[3][i] = cvtpk(p1[8 + 2 * i], p1[8 + 2 * i + 1]); }
            const LAS unsigned char* vb = lds + VB0 + cur * 16384 + vaddr;
#pragma unroll
            for (int d0 = 0; d0 < 4; ++d0) {
                s16x4 lo[4], hh[4];
#pragma unroll
                for (int ks = 0; ks < 4; ++ks) { lo[ks] = vtr(vb + d0 * 4096 + ks * 1024); hh[ks] = vtr(vb + d0 * 4096 + ks * 1024 + 512); }
                __builtin_amdgcn_sched_barrier(0);
#pragma unroll
                for (int ks = 0; ks < 4; ++ks) {
                    const bf16x8 vf = (bf16x8){lo[ks][0], lo[ks][1], lo[ks][2], lo[ks][3], hh[ks][0], hh[ks][1], hh[ks][2], hh[ks][3]};
                    o[d0] = MFMA32(__builtin_bit_cast(bf16x8, pw[ks]), vf, o[d0]);
                }
                __builtin_amdgcn_sched_barrier(0);
            }
            if (t + 1 < NT) { const int nb = cur ^ 1; *(LAS u32x4*)(lds + KB0 + nb * 8192 + kdst) = kreg; *(LAS u32x4*)(lds + VB0 + nb * 16384 + vdst0) = vreg0; *(LAS u32x4*)(lds + VB0 + nb * 16384 + vdst1) = vreg1; }
            __syncthreads();
        }
        lsum += __shfl_xor(lsum, 32);
        if (hi == 0) wsf[r32] = lsum;
        asm volatile("s_waitcnt lgkmcnt(0)" ::: "memory");
        float rli[16];
#pragma unroll
        for (int r = 0; r < 16; ++r) rli[r] = 1.0f / wsf[crow(r, hi)];
        asm volatile("s_waitcnt lgkmcnt(0)" ::: "memory");
        if (comp == 0) {
#pragma unroll
            for (int d = 0; d < 4; ++d)
#pragma unroll
                for (int i = 0; i < 8; ++i) resp[d][i >> 2][i & 3] = cvtpk(o[d][2 * i] * rli[2 * i], o[d][2 * i + 1] * rli[2 * i + 1]);
        } else {
#pragma unroll
            for (int d = 0; d < 4; ++d)
#pragma unroll
                for (int i = 0; i < 8; ++i) { const unsigned w = resp[d][i >> 2][i & 3];
                    o[d][2 * i] = bflo(w) - lam * (o[d][2 * i] * rli[2 * i]); o[d][2 * i + 1] = bfhi(w) - lam * (o[d][2 * i + 1] * rli[2 * i + 1]); }
        }
    }
    const float* sg = a.in[I_SUBG];
    float gsub[4];
#pragma unroll
    for (int d = 0; d < 4; ++d) gsub[d] = sg[32 * d + r32] * 0.8f;
    bf16_t* Y = (bf16_t*)(a.ws + WS_Y);
#pragma unroll
    for (int r = 0; r < 16; ++r) {
        float ss = o[0][r] * o[0][r] + o[1][r] * o[1][r] + o[2][r] * o[2][r] + o[3][r] * o[3][r];
#pragma unroll
        for (int of = 1; of < 32; of <<= 1) ss += __shfl_xor(ss, of);
        const float rs = 1.0f / sqrtf(ss * (1.0f / 128.0f) + EPSN);
        bf16_t* yr = Y + (size_t)(b * SEQ + qb * 256 + wid * 32 + crow(r, hi)) * DM + 128 * h + r32;
#pragma unroll
        for (int d = 0; d < 4; ++d) yr[32 * d] = (bf16_t)(cvtpk(o[d][r] * rs * gsub[d], 0.f) & 0xffffu);
    }
}
__device__ __forceinline__ void conv_phase(const Args& a, const Frame& F) {
    const bf16_t* GB = (const bf16_t*)(a.ws + WS_GB); const bf16_t* CU = (const bf16_t*)(a.ws + WS_CU); bf16_t* Y = (bf16_t*)(a.ws + WS_Y);
    const float* cw = a.in[I_CONVW];
    const int total = MTOK * 64;
    for (int i = F.vcu * 512 + F.tid; i < total; i += F.G * 512) {
        const int row = i >> 6, ch = (i & 63) * 8, t = row & (SEQ - 1);
        const u32x4 z = (u32x4){0u, 0u, 0u, 0u};
        const u32x4 c1 = *(const u32x4*)(CU + (size_t)row * 512 + ch);
        const u32x4 c0 = t > 0 ? *(const u32x4*)(CU + (size_t)(row - 1) * 512 + ch) : z;
        const u32x4 c2 = t < SEQ - 1 ? *(const u32x4*)(CU + (size_t)(row + 1) * 512 + ch) : z;
        const u32x4 gb = *(const u32x4*)(GB + (size_t)row * 512 + ch);
        u32x4 o;
#pragma unroll
        for (int j = 0; j < 4; ++j) {
            const float w0a = cw[ch + 2 * j], w0b = cw[ch + 2 * j + 1], w1a = cw[512 + ch + 2 * j], w1b = cw[512 + ch + 2 * j + 1], w2a = cw[1024 + ch + 2 * j], w2b = cw[1024 + ch + 2 * j + 1];
            const float ya = bflo(gb[j]) * (w0a * bflo(c0[j]) + w1a * bflo(c1[j]) + w2a * bflo(c2[j]));
            const float yb = bfhi(gb[j]) * (w0b * bfhi(c0[j]) + w1b * bfhi(c1[j]) + w2b * bfhi(c2[j]));
            o[j] = cvtpk(ya, yb);
        }
        *(u32x4*)(Y + (size_t)row * DM + 512 + ch) = o;
    }
}

__device__ __forceinline__ void sgu_unit(const Args& a, const Frame& F, int chunk, int grp) {
    const int lane = F.lane, r32 = lane & 31, hi = lane >> 5, wid = F.wave, tid = F.tid;
    LAS unsigned char* lds = F.lds;
    constexpr int VN0 = 0, WI0 = 65536, ST0 = 98304;
    LAS float* st = (LAS float*)(lds + ST0);
    const bf16_t* VV = (const bf16_t*)(a.ws + WS_VV); const bf16_t* U = (const bf16_t*)(a.ws + WS_U); bf16_t* T = (bf16_t*)(a.ws + WS_T);
    const bf16_t* Wsb = (const bf16_t*)(a.ws + WS_WS) + (size_t)grp * 128 * 128;
    const int tok0 = chunk * 128;
    for (int i = 0; i < 16; ++i) {
        const int q = wid * 16 + i;
        const u32x4* vr = (const u32x4*)(VV + (size_t)(tok0 + q) * DM) + lane;
        const u32x4 x0 = vr[0], x1 = vr[64];
        float s = 0.f, s2 = 0.f;
#pragma unroll
        for (int j = 0; j < 4; ++j) { const float f0 = bflo(x0[j]), f1 = bfhi(x0[j]), f2 = bflo(x1[j]), f3 = bfhi(x1[j]); s += (f0 + f1) + (f2 + f3); s2 += (f0 * f0 + f1 * f1) + (f2 * f2 + f3 * f3); }
        s = wave_sum(s); s2 = wave_sum(s2);
        const float mean = s * (1.0f / DM); const float var = fmaxf(s2 * (1.0f / DM) - mean * mean, 0.f);
        if (lane == 0) { st[2 * q] = mean; st[2 * q + 1] = 1.0f / sqrtf(var + EPSN); }
    }
    for (int i = tid; i < 2048; i += 512) { const int p = i >> 4, qc = i & 15; *(LAS u32x4*)(lds + WI0 + qc * 2048 + p * 16) = *(const u32x4*)(Wsb + p * 128 + qc * 8); }
    __syncthreads();
    const float* lng = a.in[I_SLNG] + grp * 256; const float* lnb = a.in[I_SLNB] + grp * 256;
    for (int i = tid; i < 4096; i += 512) {
        const int q = i >> 5, cc = i & 31, c = cc * 8;
        const u32x4 x = *(const u32x4*)(VV + (size_t)(tok0 + q) * DM + grp * 256 + c);
        const float mean = st[2 * q], rstd = st[2 * q + 1];
        const f32x4 g0 = *(const f32x4*)(lng + c), g1 = *(const f32x4*)(lng + c + 4), b0 = *(const f32x4*)(lnb + c), b1 = *(const f32x4*)(lnb + c + 4);
        u32x4 o;
        o.x = cvtpk((bflo(x.x) - mean) * rstd * g0[0] + b0[0], (bfhi(x.x) - mean) * rstd * g0[1] + b0[1]);
        o.y = cvtpk((bflo(x.y) - mean) * rstd * g0[2] + b0[2], (bfhi(x.y) - mean) * rstd * g0[3] + b0[3]);
        o.z = cvtpk((bflo(x.z) - mean) * rstd * g1[0] + b1[0], (bfhi(x.z) - mean) * rstd * g1[1] + b1[1]);
        o.w = cvtpk((bflo(x.w) - mean) * rstd * g1[2] + b1[2], (bfhi(x.w) - mean) * rstd * g1[3] + b1[3]);
        *(LAS u32x4*)(lds + VN0 + (cc >> 2) * 8192 + q * 64 + (cc & 3) * 16) = o;
    }
    __syncthreads();
    f32x16 acc[4];
#pragma unroll
    for (int pb = 0; pb < 4; ++pb)
#pragma unroll
        for (int r = 0; r < 16; ++r) acc[pb][r] = 0.f;
    const LAS unsigned char* vbase = lds + VN0 + wid * 8192 + ((lane >> 4) & 1) * 32 + (lane & 3) * 8 + (8 * hi + ((lane & 15) >> 2)) * 64;
#pragma unroll
    for (int ks = 0; ks < 8; ++ks) {
        const s16x4 lo = vtr(vbase + ks * 1024), hh = vtr(vbase + ks * 1024 + 256);
        const bf16x8 af = (bf16x8){lo[0], lo[1], lo[2], lo[3], hh[0], hh[1], hh[2], hh[3]};
#pragma unroll
        for (int pb = 0; pb < 4; ++pb) {
            const bf16x8 bfr = *(const LAS bf16x8*)(lds + WI0 + (2 * ks + hi) * 2048 + (pb * 32 + r32) * 16);
            acc[pb] = MFMA32(af, bfr, acc[pb]);
        }
    }
    const float* bs = a.in[I_SBS] + grp * 128;
#pragma unroll
    for (int pb = 0; pb < 4; ++pb) {
        const int p = pb * 32 + r32; const float bias = bs[p];
        const size_t rowo = (size_t)(tok0 + p) * DM + grp * 256 + wid * 32 + 4 * hi;
#pragma unroll
        for (int rg = 0; rg < 4; ++rg) {
            const u32x2 uu = *(const u32x2*)(U + rowo + 8 * rg);
            u32x2 w;
            w.x = cvtpk(bflo(uu.x) * (acc[pb][4 * rg] + bias), bfhi(uu.x) * (acc[pb][4 * rg + 1] + bias));
            w.y = cvtpk(bflo(uu.y) * (acc[pb][4 * rg + 2] + bias), bfhi(uu.y) * (acc[pb][4 * rg + 3] + bias));
            *(u32x2*)(T + rowo + 8 * rg) = w;
        }
    }
    __syncthreads();
}

__device__ __forceinline__ void route_phase(const Args& a, const Frame& F, const float* h) {
    const float* mod = (const float*)(a.ws + WS_MOD) + (size_t)1 * 9 * 6144;
    bf16_t* XN = (bf16_t*)(a.ws + WS_XN);
    LAS float* rw = (LAS float*)F.lds;
    for (int i = F.tid; i < 2048; i += 512) *(LAS f32x4*)(rw + 4 * i) = *(const f32x4*)(a.in[I_RW] + 4 * i);
    __syncthreads();
    unsigned* cnt = (unsigned*)(a.ws + WS_CTL) + CW_CNT;
    int* list = (int*)(a.ws + WS_LIST); int* tinfo = (int*)(a.ws + WS_TINFO); float* tgate = (float*)(a.ws + WS_TGATE);
    const float* g = a.in[I_NFFNG] + DM;
    const int gw = F.vcu * 8 + F.wave, ngw = F.G * 8, lane = F.lane;
    for (int m = gw; m < MTOK; m += ngw) {
        const float* mb = mod + (size_t)(m >> 11) * 6144; f32x4 y[4];
        modulate_row(h + (size_t)m * DM, XN + (size_t)m * DM, g, mb + 3 * 1024, mb + 4 * 1024, lane, y);
        float lg[8];
#pragma unroll
        for (int e = 0; e < 8; ++e) lg[e] = 0.f;
#pragma unroll
        for (int j = 0; j < 4; ++j)
#pragma unroll
            for (int i = 0; i < 4; ++i) { const int k = 4 * (lane + 64 * j) + i; const f32x4 w0 = *(const LAS f32x4*)(rw + 8 * k), w1 = *(const LAS f32x4*)(rw + 8 * k + 4); const float x = y[j][i];
                lg[0] += x * w0[0]; lg[1] += x * w0[1]; lg[2] += x * w0[2]; lg[3] += x * w0[3]; lg[4] += x * w1[0]; lg[5] += x * w1[1]; lg[6] += x * w1[2]; lg[7] += x * w1[3]; }
#pragma unroll
        for (int e = 0; e < 8; ++e) lg[e] = wave_sum(lg[e]);
        int e0 = 0; float v0 = lg[0];
#pragma unroll
        for (int e = 1; e < 8; ++e) if (lg[e] > v0) { v0 = lg[e]; e0 = e; }
        int e1 = -1; float v1 = -3.0e38f;
#pragma unroll
        for (int e = 0; e < 8; ++e) if (e != e0 && lg[e] > v1) { v1 = lg[e]; e1 = e; }
        if (lane == 0) {
            const float g1 = 1.0f / (1.0f + __expf(v1 - v0));
            const int p0 = (int)atomicAdd(cnt + 64 * e0, 1u), p1 = (int)atomicAdd(cnt + 64 * e1, 1u);
            list[e0 * MOE_CAP + p0] = m; list[e1 * MOE_CAP + p1] = m;
            tinfo[4 * m] = e0; tinfo[4 * m + 1] = e1; tinfo[4 * m + 2] = p0; tinfo[4 * m + 3] = p1;
            tgate[2 * m] = g1; tgate[2 * m + 1] = 1.0f - g1;
        }
    }
}
__device__ __forceinline__ void combine_phase(const Args& a, const Frame& F) {
    const float* mod = (const float*)(a.ws + WS_MOD) + (size_t)1 * 9 * 6144;
    const unsigned* cnt = (const unsigned*)(a.ws + WS_CTL) + CW_CNT;
    const int* tinfo = (const int*)(a.ws + WS_TINFO); const float* tgate = (const float*)(a.ws + WS_TGATE);
    const float* PO = (const float*)(a.ws + WS_PO);
    int base[8]; { int b = 0;
#pragma unroll
        for (int e = 0; e < 8; ++e) { base[e] = b; int c = (int)cnt[64 * e]; c = c > MOE_CAP ? MOE_CAP : c; b += ((c + 255) >> 8) << 8; } }
    const int gw = F.vcu * 8 + F.wave, ngw = F.G * 8, lane = F.lane;
    for (int m = gw; m < MTOK; m += ngw) {
        const int e0 = tinfo[4 * m], e1 = tinfo[4 * m + 1], p0 = tinfo[4 * m + 2], p1 = tinfo[4 * m + 3];
        int b0 = 0, b1 = 0;
#pragma unroll
        for (int e = 0; e < 8; ++e) { if (e == e0) b0 = base[e]; if (e == e1) b1 = base[e]; }
        const float g0 = tgate[2 * m], g1 = tgate[2 * m + 1];
        const f32x4* r0 = (const f32x4*)(PO + (size_t)(b0 + p0) * DM) + lane; const f32x4* r1 = (const f32x4*)(PO + (size_t)(b1 + p1) * DM) + lane;
        const f32x4* gf = (const f32x4*)(mod + (size_t)(m >> 11) * 6144 + 5 * 1024) + lane;
        f32x4* o = (f32x4*)(a.out + (size_t)m * DM) + lane;
#pragma unroll
        for (int j = 0; j < 4; ++j) o[64 * j] = o[64 * j] + gf[64 * j] * (r0[64 * j] * g0 + r1[64 * j] * g1);
    }
}

__global__ void __launch_bounds__(512, 2) mk_fwd(Args args) {
    extern __shared__ __attribute__((aligned(16))) unsigned char lds_raw[];
    Frame F;
    F.lds = (LAS unsigned char*)lds_raw;
    F.tid = threadIdx.x; F.lane = F.tid & 63; F.wave = __builtin_amdgcn_readfirstlane(F.tid >> 6);
    F.G = gridDim.x; { const int bx = blockIdx.x; F.vcu = (F.G % 8 == 0) ? (bx % 8) * (F.G / 8) + bx / 8 : bx; }
    F.ws = args.ws;
    unsigned char* ws = args.ws;
    volatile LAS unsigned* MISC = (volatile LAS unsigned*)(F.lds + MISC_OFF);
    for (int u = F.tid; u < (LDS_BYTES - LDSCTL_OFF) / 4; u += 512) ((LAS unsigned*)(F.lds + LDSCTL_OFF))[u] = 0u;
    __syncthreads();
    unsigned* ctl = (unsigned*)(ws + WS_CTL);
    XcdBarrier bar; bar.bar = ctl + CW_BAR; bar.x = 0; bar.st = nullptr;
#if !MK_PER_PHASE
    bar = xcd_barrier_post(ctl + CW_BAR, MISC + 8);
#endif
    const int lo = args.ph_lo, hi = args.ph_hi;
#ifndef MK_PHASES
#define MK_PHASES 0x1ffff
#endif
#define IN(k) (((MK_PHASES >> (k)) & 1) && lo <= (k) && (k) < hi)
#if MK_PER_PHASE
#define SEAM(k) do { } while (0)
#else
#define SEAM(k) do { if (IN(k) && IN((k) + 1)) xcd_barrier(bar); } while (0)
#endif
    const int gw = F.vcu * 8 + F.wave, ngw = F.G * 8;
    float* H = args.out;
    const float* mod0 = (const float*)(ws + WS_MOD); const float* mod1 = mod0 + 9 * 6144;

    if (IN(0)) {
        ada_phase(args, F);
        if (F.vcu == F.G - 1) tables_phase(args, F);
        __syncthreads();
        conv_range(args, F, JB_WIN, JB_WOUT, gw, ngw);
    }
    SEAM(0);
    if (IN(1)) {
        modulate_phase(args, F, args.in[I_X], 0, args.in[I_NMIXG], 0, 1);
        { bf16_t* HC = (bf16_t*)(ws + WS_HC); const float* mb = mod0 + (size_t)8 * 6144;
          for (int m = gw; m < MCTX; m += ngw) { f32x4 y[4]; modulate_row(args.in[I_CTX] + (size_t)m * DM, HC + (size_t)m * DM, args.in[I_NMIXG], mb, mb + 1024, F.lane, y); } }
        { const float* wsrc = args.in[I_SWS]; bf16_t* wd = (bf16_t*)(ws + WS_WS);
          for (int i = F.vcu * 512 + F.tid; i < 4 * 128 * 128 / 4; i += F.G * 512) { const f32x4 v = *(const f32x4*)(wsrc + 4 * i); u32x2 w; w.x = cvtpk(v[0], v[1]); w.y = cvtpk(v[2], v[3]); *(u32x2*)(wd + 4 * i) = w; } }
        conv_range(args, F, JB_WOUT, JB_MGU, gw, ngw);
    }
    SEAM(1);
    if (IN(2)) {
        if (F.vcu < 32) {
            pg8::Gemm g{(const bf16_t*)(ws + WS_HC), (const bf16_t*)(ws + WS_WIN) + (size_t)512 * DM, MCTX, 1024, DM, 0, nullptr};
            pg8::StaticOrder S; S.init(MCTX, 1024, 32, F.vcu);
            pg8::EpiInProj E{(bf16_t*)(ws + WS_Q), (bf16_t*)(ws + WS_K), (bf16_t*)(ws + WS_V), (bf16_t*)(ws + WS_GB), (bf16_t*)(ws + WS_CU), args.in[I_QG], args.in[I_KG], (const float*)(ws + WS_ROPEC), (const float*)(ws + WS_ROPES), 1};
            pg8::gemm_phase<pg8::EpiInProj, pg8::StaticOrder, false, false>(F.lds, g, S, E);
        } else if (F.G > 32) {
            conv_range(args, F, JB_MGU, JB_END, (F.vcu - 32) * 8 + F.wave, (F.G - 32) * 8);
        }
    }
    SEAM(2);
    if (IN(3)) {
        pg8::Gemm g{(const bf16_t*)(ws + WS_XN), (const bf16_t*)(ws + WS_WIN), MTOK, NIN, DM, 0, nullptr};
        pg8::StaticOrder S; S.init(MTOK, NIN, F.G, (int)blockIdx.x);
        pg8::EpiInProj E{(bf16_t*)(ws + WS_Q), (bf16_t*)(ws + WS_K), (bf16_t*)(ws + WS_V), (bf16_t*)(ws + WS_GB), (bf16_t*)(ws + WS_CU), args.in[I_QG], args.in[I_KG], (const float*)(ws + WS_ROPEC), (const float*)(ws + WS_ROPES), 0};
        pg8::gemm_phase<pg8::EpiInProj, pg8::StaticOrder, true, false>(F.lds, g, S, E);
    }
    SEAM(3);
    if (IN(4)) {
        for (int u = F.vcu; u < NB * 4 * 8; u += F.G) attn_unit(args, F, u >> 5, (u >> 3) & 3, u & 7);
        conv_phase(args, F);
    }
    SEAM(4);
    if (IN(5)) {
        pg8::Gemm g{(const bf16_t*)(ws + WS_Y), (const bf16_t*)(ws + WS_WOUT), MTOK, DM, DM, 0, nullptr};
        pg8::StaticOrder S; S.init(MTOK, DM, F.G, (int)blockIdx.x);
        pg8::EpiResid E{args.in[I_X], H, mod0 + 2 * 1024};
        pg8::gemm_phase<pg8::EpiResid, pg8::StaticOrder, false, false>(F.lds, g, S, E);
    }
    SEAM(5);
    if (IN(6)) modulate_phase(args, F, H, 0, args.in[I_NFFNG], 3, 4);
    SEAM(6);
    if (IN(7)) {
        pg8::Gemm g{(const bf16_t*)(ws + WS_XN), (const bf16_t*)(ws + WS_WGU), MTOK, 2 * DFF, DM, 0, nullptr};
        pg8::StaticOrder S; S.init(MTOK, 2 * DFF, F.G, (int)blockIdx.x);
        pg8::EpiSwiGLU E{(bf16_t*)(ws + WS_G), DFF};
        pg8::gemm_phase<pg8::EpiSwiGLU, pg8::StaticOrder, true, false>(F.lds, g, S, E);
    }
    SEAM(7);
    if (IN(8)) {
        pg8::Gemm g{(const bf16_t*)(ws + WS_G), (const bf16_t*)(ws + WS_WD), MTOK, DM, DFF, 0, nullptr};
        pg8::StaticOrder S; S.init(MTOK, DM, F.G, (int)blockIdx.x);
        pg8::EpiResid E{H, H, mod0 + 5 * 1024};
        pg8::gemm_phase<pg8::EpiResid, pg8::StaticOrder, false, false>(F.lds, g, S, E);
    }
    SEAM(8);
    if (IN(9)) modulate_phase(args, F, H, 1, args.in[I_NMIXG] + DM, 0, 1);
    SEAM(9);
    if (IN(10)) {
        pg8::Gemm g{(const bf16_t*)(ws + WS_XN), (const bf16_t*)(ws + WS_WSI), MTOK, 2 * DM, DM, 0, nullptr};
        pg8::StaticOrder S; S.init(MTOK, 2 * DM, F.G, (int)blockIdx.x);
        pg8::EpiSguIn E{(bf16_t*)(ws + WS_U), (bf16_t*)(ws + WS_VV)};
        pg8::gemm_phase<pg8::EpiSguIn, pg8::StaticOrder, true, false>(F.lds, g, S, E);
    }
    SEAM(10);
    if (IN(11)) { for (int u = F.vcu; u < 128 * 4; u += F.G) sgu_unit(args, F, u >> 2, u & 3); }
    SEAM(11);
    if (IN(12)) {
        pg8::Gemm g{(const bf16_t*)(ws + WS_T), (const bf16_t*)(ws + WS_WSO), MTOK, DM, DM, 0, nullptr};
        pg8::StaticOrder S; S.init(MTOK, DM, F.G, (int)blockIdx.x);
        pg8::EpiResid E{H, H, mod1 + 2 * 1024};
        pg8::gemm_phase<pg8::EpiResid, pg8::StaticOrder, false, false>(F.lds, g, S, E);
    }
    SEAM(12);
    if (IN(13)) route_phase(args, F, H);
    SEAM(13);
    if (IN(14)) {
        pg8::Gemm g{(const bf16_t*)(ws + WS_XN), (const bf16_t*)(ws + WS_MGU), MOE_ROWS, 2 * DFE, DM, (size_t)(2 * DFE) * DM * 2, (const int*)(ws + WS_LIST)};
        pg8::MoeOrder S; S.init(ctl + CW_CNT, 2 * DFE / 256, F.G, F.vcu);
        pg8::EpiSwiGLU E{(bf16_t*)(ws + WS_GE), DFE};
        pg8::gemm_phase<pg8::EpiSwiGLU, pg8::MoeOrder, true, true>(F.lds, g, S, E);
    }
    SEAM(14);
    if (IN(15)) {
        pg8::Gemm g{(const bf16_t*)(ws + WS_GE), (const bf16_t*)(ws + WS_MD), MOE_ROWS, DM, DFE, (size_t)DM * DFE * 2, nullptr};
        pg8::MoeOrder S; S.init(ctl + CW_CNT, DM / 256, F.G, F.vcu);
        pg8::EpiF32 E{(float*)(ws + WS_PO)};
        pg8::gemm_phase<pg8::EpiF32, pg8::MoeOrder, true, false>(F.lds, g, S, E);
    }
    SEAM(15);
    if (IN(16)) combine_phase(args, F);
#undef IN
#undef SEAM
}

extern "C" void kernel_launch(void* const* d_in, const int* in_sizes, int n_in, void* d_out, int out_size, void* d_ws, size_t ws_size, hipStream_t stream) {
    static int grid = 0;
    if (grid == 0) {
        if (n_in != 31 || out_size != MTOK * DM || ws_size < WS_END) { fprintf(stderr, "kernel_launch: unexpected problem (n_in %d, out %d, ws %zu < %zu)\n", n_in, out_size, ws_size, (size_t)WS_END); grid = -1; return; }
        int dev = 0, cus = 0, per_cu = 0;
        if (hipGetDevice(&dev) != hipSuccess || hipDeviceGetAttribute(&cus, hipDeviceAttributeMultiprocessorCount, dev) != hipSuccess) { grid = -1; return; }
        if (hipFuncSetAttribute((const void*)mk_fwd, hipFuncAttributeMaxDynamicSharedMemorySize, LDS_BYTES) != hipSuccess) { fprintf(stderr, "kernel_launch: hipFuncSetAttribute failed\n"); grid = -1; return; }
        if (hipOccupancyMaxActiveBlocksPerMultiprocessor(&per_cu, (const void*)mk_fwd, 512, LDS_BYTES) != hipSuccess || per_cu < 1) { fprintf(stderr, "kernel_launch: occupancy query says %d blocks per CU\n", per_cu); (void)hipGetLastError(); grid = -1; return; }
        grid = cus;
        if (grid % 8 != 0 || grid < 64) { fprintf(stderr, "kernel_launch: unexpected CU count %d\n", cus); }
    }
    if (grid < 0) return;
    (void)hipMemsetAsync((char*)d_ws + WS_CTL, 0, CTL_ZERO_BYTES, stream);
    Args a{};
    for (int i = 0; i < 31; ++i) a.in[i] = (const float*)d_in[i];
    a.out = (float*)d_out; a.ws = (unsigned char*)d_ws;
#if MK_PER_PHASE
    for (int p = 0; p < NPH; ++p) { a.ph_lo = p; a.ph_hi = p + 1; hipLaunchKernelGGL(mk_fwd, dim3(grid), dim3(512), LDS_BYTES, stream, a); }
#else
    a.ph_lo = 0; a.ph_hi = NPH;
    hipLaunchKernelGGL(mk_fwd, dim3(grid), dim3(512), LDS_BYTES, stream, a);
#endif
}
```
